# Optimizing an MI355X kernel written in HIP

```python
import math
import jax, jax.numpy as jnp
from jax import lax
import numpy as np

D_MODEL = 1024
BATCH = 16
SEQ = 4096
DEPTH = 1
DEC_BATCH = 8
DEC_SEQ = 4096
PAST_LEN = 128

D_MIX = D_MODEL
D_LRU = D_MIX // 2
D_POOL = D_MIX - D_LRU
LRU_HEADS = 8
LRU_HEAD_DIM = D_LRU // LRU_HEADS
CONV_WIDTH = 4
CONV_LEFT = 2
RG_C = 8.0
POOL_WINDOWS = (2, 4, 8, 16)
POOL_GROUPS = len(POOL_WINDOWS)
POOL_GROUP_DIM = D_POOL // POOL_GROUPS
D_FF = int(math.ceil((8 * D_MODEL / 3) / 256) * 256)
N_DIR = 2
EPS = 1e-6

kernel_name = "hymba_rglru_pool_encoder"


def rms_norm(x, g):
    xf = x.astype(jnp.float32)
    y = xf * lax.rsqrt(jnp.mean(xf * xf, axis=-1, keepdims=True) + EPS)
    return (y * g.astype(jnp.float32)).astype(x.dtype)


def centred_depthwise_conv(u, w, b):
    S = u.shape[1]
    up = jnp.pad(u, ((0, 0), (CONV_LEFT, CONV_WIDTH - 1 - CONV_LEFT), (0, 0)))
    out = b
    for k in range(CONV_WIDTH):
        out = out + up[:, k:k + S] * w[k]
    return out


def _linear_combine(c1, c2):
    a1, b1 = c1
    a2, b2 = c2
    return a1 * a2, a2 * b1 + b2


def rg_lru_direction(u, w_a, b_a, w_x, b_x, lam, reverse):
    B, S, C = u.shape
    uh = u.reshape(B, S, LRU_HEADS, LRU_HEAD_DIM)
    r = jax.nn.sigmoid(jnp.einsum('bshi,hij->bshj', uh, w_a.astype(jnp.float32)).reshape(B, S, C) + b_a.astype(jnp.float32))
    i = jax.nn.sigmoid(jnp.einsum('bshi,hij->bshj', uh, w_x.astype(jnp.float32)).reshape(B, S, C) + b_x.astype(jnp.float32))
    log_a = -RG_C * r * jax.nn.softplus(-lam.astype(jnp.float32))
    a = jnp.exp(log_a)
    mult = jnp.sqrt(jnp.maximum(-jnp.expm1(2.0 * log_a), 0.0))
    bterm = mult * (i * u)
    _, h = lax.associative_scan(_linear_combine, (a, bterm), axis=1, reverse=reverse)
    return h


def centred_window_mean(u, w):
    S = u.shape[1]
    half = w // 2
    up = jnp.pad(u, ((0, 0), (half, w - half - 1), (0, 0)))
    cs = jnp.pad(lax.cumsum(up, axis=1), ((0, 0), (1, 0), (0, 0)))
    sums = cs[:, w:w + S] - cs[:, :S]
    t = np.arange(S)
    count = (np.minimum(t + w - half, S) - np.maximum(t - half, 0)).astype(np.float32)
    return sums / jnp.asarray(count)[None, :, None]


def pool_mixer(u, pool_w, pool_b, pool_scale):
    B, S, _ = u.shape
    uf = u.astype(jnp.float32)
    groups = []
    for g, w in enumerate(POOL_WINDOWS):
        ug = uf[..., g * POOL_GROUP_DIM:(g + 1) * POOL_GROUP_DIM]
        groups.append(centred_window_mean(ug, w) - ug)
    pg = jnp.stack(groups, axis=2).astype(u.dtype)
    y = jnp.einsum('bsgi,gij->bsgj', pg, pool_w).reshape(B, S, D_POOL) + pool_b
    return y * pool_scale


def token_mixer(h, w_in, conv_w, conv_b, rg_wa, rg_ba, rg_wx, rg_bx, rg_lam, pool_w, pool_b, pool_scale, w_out):
    proj = h @ w_in
    u_lru = proj[..., :D_LRU]
    gate = proj[..., D_LRU:2 * D_LRU]
    u_pool = proj[..., 2 * D_LRU:]
    u = centred_depthwise_conv(u_lru, conv_w, conv_b).astype(jnp.float32)
    h_fwd = rg_lru_direction(u, rg_wa[0], rg_ba[0], rg_wx[0], rg_bx[0], rg_lam[0], reverse=False)
    h_bwd = rg_lru_direction(u, rg_wa[1], rg_ba[1], rg_wx[1], rg_bx[1], rg_lam[1], reverse=True)
    y_lru = ((h_fwd + h_bwd) * jax.nn.gelu(gate.astype(jnp.float32))).astype(h.dtype)
    y_pool = pool_mixer(u_pool, pool_w, pool_b, pool_scale)
    return jnp.concatenate([y_lru, y_pool], axis=-1) @ w_out


def swiglu_ffn(h, w_gate, w_up, w_down):
    return (jax.nn.silu(h @ w_gate) * (h @ w_up)) @ w_down


def encoder_layer(x, l, pre_norm_mix, post_norm_mix, w_in, conv_w, conv_b, rg_wa, rg_ba, rg_wx, rg_bx, rg_lam,
                  pool_w, pool_b, pool_scale, w_out, pre_norm_ffn, post_norm_ffn, w_gate, w_up, w_down):
    h = rms_norm(x, pre_norm_mix[l])
    m = token_mixer(h, w_in[l], conv_w[l], conv_b[l], rg_wa[l], rg_ba[l], rg_wx[l], rg_bx[l], rg_lam[l],
                    pool_w[l], pool_b[l], pool_scale[l], w_out[l])
    x = x + rms_norm(m, post_norm_mix[l])
    h = rms_norm(x, pre_norm_ffn[l])
    f = swiglu_ffn(h, w_gate[l], w_up[l], w_down[l])
    return x + rms_norm(f, post_norm_ffn[l])


def setup_inputs(seed: int = 0) -> dict:
    key = jax.random.key(seed)
    ks = jax.random.split(key, 24)
    f32 = jnp.float32

    def nrm(k, shape, scale):
        return jax.random.normal(k, shape, f32) * scale

    a8 = jax.random.uniform(ks[10], (DEPTH, N_DIR, D_LRU), f32, minval=0.9, maxval=0.999)
    a_base = a8 ** (1.0 / RG_C)
    rg_lam = jnp.log(a_base) - jnp.log1p(-a_base)
    return {
        "x_prompt": nrm(ks[0], (BATCH, SEQ, D_MODEL), 1.0),
        "x_sample": nrm(ks[1], (DEC_BATCH, DEC_SEQ, D_MODEL), 1.0),
        "pre_norm_mix": 1.0 + nrm(ks[2], (DEPTH, D_MODEL), 0.05),
        "post_norm_mix": 1.0 + nrm(ks[3], (DEPTH, D_MODEL), 0.05),
        "w_in": nrm(ks[4], (DEPTH, D_MODEL, 2 * D_LRU + D_POOL), D_MODEL ** -0.5),
        "conv_w": nrm(ks[5], (DEPTH, CONV_WIDTH, D_LRU), CONV_WIDTH ** -0.5),
        "conv_b": nrm(ks[6], (DEPTH, D_LRU), 0.01),
        "rg_wa": nrm(ks[7], (DEPTH, N_DIR, LRU_HEADS, LRU_HEAD_DIM, LRU_HEAD_DIM), LRU_HEAD_DIM ** -0.5),
        "rg_ba": nrm(ks[8], (DEPTH, N_DIR, D_LRU), 0.1),
        "rg_wx": nrm(ks[9], (DEPTH, N_DIR, LRU_HEADS, LRU_HEAD_DIM, LRU_HEAD_DIM), LRU_HEAD_DIM ** -0.5),
        "rg_bx": nrm(ks[11], (DEPTH, N_DIR, D_LRU), 0.1),
        "rg_lam": rg_lam,
        "pool_w": nrm(ks[12], (DEPTH, POOL_GROUPS, POOL_GROUP_DIM, POOL_GROUP_DIM), POOL_GROUP_DIM ** -0.5),
        "pool_b": nrm(ks[13], (DEPTH, D_POOL), 0.01),
        "pool_scale": 1.0 + nrm(ks[14], (DEPTH, D_POOL), 0.1),
        "w_out": nrm(ks[15], (DEPTH, D_MIX, D_MODEL), D_MIX ** -0.5),
        "pre_norm_ffn": 1.0 + nrm(ks[16], (DEPTH, D_MODEL), 0.05),
        "post_norm_ffn": 1.0 + nrm(ks[17], (DEPTH, D_MODEL), 0.05),
        "w_gate": nrm(ks[18], (DEPTH, D_MODEL, D_FF), D_MODEL ** -0.5),
        "w_up": nrm(ks[19], (DEPTH, D_MODEL, D_FF), D_MODEL ** -0.5),
        "w_down": nrm(ks[20], (DEPTH, D_FF, D_MODEL), D_FF ** -0.5),
    }


def reference(x_prompt, x_sample, pre_norm_mix, post_norm_mix, w_in, conv_w, conv_b, rg_wa, rg_ba, rg_wx, rg_bx,
              rg_lam, pool_w, pool_b, pool_scale, w_out, pre_norm_ffn, post_norm_ffn, w_gate, w_up, w_down):
    y_prompt = x_prompt
    y_sample = x_sample
    for l in range(DEPTH):
        y_prompt = encoder_layer(y_prompt, l, pre_norm_mix, post_norm_mix, w_in, conv_w, conv_b, rg_wa, rg_ba,
                                 rg_wx, rg_bx, rg_lam, pool_w, pool_b, pool_scale, w_out, pre_norm_ffn,
                                 post_norm_ffn, w_gate, w_up, w_down)
        y_sample = encoder_layer(y_sample, l, pre_norm_mix, post_norm_mix, w_in, conv_w, conv_b, rg_wa, rg_ba,
                                 rg_wx, rg_bx, rg_lam, pool_w, pool_b, pool_scale, w_out, pre_norm_ffn,
                                 post_norm_ffn, w_gate, w_up, w_down)
    return (y_prompt, y_sample)
```

```cpp
#include <hip/hip_runtime.h>
#include <hip/hip_cooperative_groups.h>
#include <cstdio>
#include <cstdint>
namespace cg = cooperative_groups;
#ifndef MK_N_LAUNCHES
#define MK_N_LAUNCHES 8
#endif
namespace pg8 {
#define PG8_LAS __attribute__((address_space(3)))
typedef unsigned short bf16_t;
typedef short bf16x8 __attribute__((ext_vector_type(8)));
typedef float f32x4 __attribute__((ext_vector_type(4)));
typedef unsigned u32x4 __attribute__((ext_vector_type(4)));
constexpr int BM = 256, BK = 64, HALF = 128, HTB = HALF * BK * 2  , STAGE_BYTES = 8 * HTB, NXCD = 8, WGM = 8;

__host__ __device__ __forceinline__ int lds_byte(int r, int c) { const int st = (r >> 4) * 2 + (c >> 5), rr = r & 15, cc = c & 31, ob = rr * 64 + cc * 2; return st * 1024 + (ob ^ (((ob >> 9) & 1) << 5)); }
__host__ __device__ __forceinline__ void stage_rc(int b, int& R, int& C) { const int st = b / 1024, sb = b % 1024, swz = sb ^ (((sb >> 9) & 1) << 5); R = (st >> 1) * 16 + swz / 64; C = (st & 1) * 32 + (swz % 64) / 2; }
__host__ __device__ __forceinline__ int perm32(int rho) { const int n = rho >> 4, i = rho & 15; return 8 * (i >> 2) + 4 * n + (i & 3); }

struct Unit { int pm, pn; };
struct Gemm { const bf16_t* A; const bf16_t* Bt; int M, N, K; };

struct StaticOrder {
    int nM, nN, nwg, G, c;
    __host__ __device__ void init(int M, int N, int G_, int c_) { nM = M / BM; nN = N / BM; nwg = nM * nN; G = G_; c = c_; }
    __host__ __device__ bool next(int i, Unit& u) const {
        const long L = (long)i * G + c; if (L >= nwg) return false;
        int wgid = (int)L; { const int q = nwg / NXCD, r = nwg % NXCD, xcd = wgid % NXCD, off = wgid / NXCD; wgid = (xcd < r ? xcd * (q + 1) : r * (q + 1) + (xcd - r) * q) + off; }
        const int nig = WGM * nN, gid = wgid / nig, fm = gid * WGM, gsz = (nM - fm) < WGM ? (nM - fm) : WGM;
        u.pm = fm + ((wgid % nig) % gsz); u.pn = (wgid % nig) / gsz; return true;
    }
    __device__ __forceinline__ void a_ready(const Unit&) const {}
    __device__ __forceinline__ void done(const Unit&) const {}
};

__device__ __forceinline__ unsigned cvt_pk_bf16(float lo, float hi) { unsigned r; asm volatile("v_cvt_pk_bf16_f32 %0, %1, %2" : "=v"(r) : "v"(lo), "v"(hi)); return r; }
struct EpiBf16 {
    static constexpr bool PERM = true, AFTER_DRAIN = false;
    bf16_t* O; int ldc;
    __device__ __forceinline__ void operator()(const f32x4 (&acc)[2][2][4][2], const Unit& u, int wr, int wc, int fr, int fq) const {
        const int row0 = u.pm * BM + wr * 64 + fr; const int col0 = u.pn * BM + wc * 32 + 8 * fq;
#pragma unroll
        for (int ai = 0; ai < 2; ++ai)
#pragma unroll
            for (int m = 0; m < 4; ++m) { bf16_t* rowp = O + (size_t)(row0 + ai * HALF + m * 16) * ldc + col0;
#pragma unroll
                for (int bj = 0; bj < 2; ++bj) { const f32x4 v0 = acc[ai][bj][m][0], v1 = acc[ai][bj][m][1];
                    u32x4 w; w.x = cvt_pk_bf16(v0[0], v0[1]); w.y = cvt_pk_bf16(v0[2], v0[3]); w.z = cvt_pk_bf16(v1[0], v1[1]); w.w = cvt_pk_bf16(v1[2], v1[3]);
                    *(u32x4*)(rowp + bj * HALF) = w; } }
    }
};
__device__ __forceinline__ float silu_mul(float g, float u) { return g * u * __builtin_amdgcn_rcpf(1.0f + __builtin_amdgcn_exp2f(g * -1.44269504089f)); }
struct EpiSwiGLU {
    static constexpr bool PERM = true, AFTER_DRAIN = false;
    bf16_t* O; int ldc;
    __device__ __forceinline__ void operator()(const f32x4 (&acc)[2][2][4][2], const Unit& u, int wr, int wc, int fr, int fq) const {
        const int row0 = u.pm * BM + wr * 64 + fr; const int col0 = u.pn * HALF + wc * 32 + 8 * fq;
#pragma unroll
        for (int ai = 0; ai < 2; ++ai)
#pragma unroll
            for (int m = 0; m < 4; ++m) { bf16_t* rowp = O + (size_t)(row0 + ai * HALF + m * 16) * ldc + col0;
                const f32x4 g0 = acc[ai][0][m][0], g1 = acc[ai][0][m][1], u0 = acc[ai][1][m][0], u1 = acc[ai][1][m][1];
                u32x4 w; w.x = cvt_pk_bf16(silu_mul(g0[0], u0[0]), silu_mul(g0[1], u0[1])); w.y = cvt_pk_bf16(silu_mul(g0[2], u0[2]), silu_mul(g0[3], u0[3]));
                w.z = cvt_pk_bf16(silu_mul(g1[0], u1[0]), silu_mul(g1[1], u1[1])); w.w = cvt_pk_bf16(silu_mul(g1[2], u1[2]), silu_mul(g1[3], u1[3]));
                *(u32x4*)rowp = w; }
    }
};

template <class Epi, class Sched, bool ALIGN_EPI = false, bool SP2 = false>
__device__ __forceinline__ void gemm_phase(PG8_LAS unsigned char* lds, const Gemm g, const Sched& S, const Epi& E) {
    const int tid = threadIdx.x, wid = __builtin_amdgcn_readfirstlane(tid >> 6), lane = tid & 63, wr = wid >> 2, wc = wid & 3, fr = lane & 15, fq = lane >> 4;
    const int K = g.K, nt = K / BK;
    unsigned voffA[2], voffB[2];
#pragma unroll
    for (int i = 0; i < 2; ++i) { int R, C; stage_rc(tid * 16 + i * 8192, R, C); const int Rb = Epi::PERM ? ((R & ~31) + perm32(R & 31)) : R;
        voffA[i] = (unsigned)(R * K + C) * 2u; voffB[i] = (unsigned)(Rb * K + C) * 2u; }
    const size_t kstep = (size_t)(BK * 2);
    const size_t hstep = (size_t)HALF * K * 2;
    const size_t tstep = 2 * hstep;
    const unsigned ldsw = (unsigned)wid * 1024u;
    const int aoff = lds_byte(wr * 64 + fr, fq * 8), boff = lds_byte(wc * 32 + fr, fq * 8);
#define PG8_SA(b, h) (((b) * 2 + (h)) * HTB)
#define PG8_SB(b, h) ((4 + (b) * 2 + (h)) * HTB)
#define PG8_STAGE(bufoff, gbase, voff) do { _Pragma("unroll") for (int _i = 0; _i < 2; ++_i) \
        __builtin_amdgcn_global_load_lds((const unsigned*)((const char*)(gbase) + (voff)[_i]), (PG8_LAS unsigned*)(lds + (bufoff) + ldsw + _i * 8192), 16, 0, 0); } while (0)
#define PG8_LDA(dst, b, h) do { _Pragma("unroll") for (int m = 0; m < 4; ++m) _Pragma("unroll") for (int k = 0; k < 2; ++k) dst[m][k] = *(const PG8_LAS bf16x8*)(lds + PG8_SA(b, h) + aoff + m * 2048 + k * 1024); } while (0)
#define PG8_LDB(dst, b, h) do { _Pragma("unroll") for (int n = 0; n < 2; ++n) _Pragma("unroll") for (int k = 0; k < 2; ++k) dst[n][k] = *(const PG8_LAS bf16x8*)(lds + PG8_SB(b, h) + boff + n * 2048 + k * 1024); } while (0)
#define PG8_MMA(ai, bj, At, Bt) do { __builtin_amdgcn_s_setprio(1); _Pragma("unroll") for (int m = 0; m < 4; ++m) _Pragma("unroll") for (int n = 0; n < 2; ++n) _Pragma("unroll") for (int k = 0; k < 2; ++k) \
        acc[ai][bj][m][n] = __builtin_amdgcn_mfma_f32_16x16x32_bf16(Bt[n][k], At[m][k], acc[ai][bj][m][n], 0, 0, 0); __builtin_amdgcn_s_setprio(0); } while (0)
#define PG8_WAIT_V(n) asm volatile("s_waitcnt vmcnt(" #n ")" ::: "memory")
#define PG8_WAIT_L(n) asm volatile("s_waitcnt lgkmcnt(" #n ")" ::: "memory")
#define PG8_BAR __builtin_amdgcn_s_barrier()
#define PG8_SCHED __builtin_amdgcn_sched_barrier(0)
    Unit cur, nxt; int ui = 0;
    if (!S.next(0, cur)) return;
    f32x4 acc[2][2][4][2];
#pragma unroll
    for (int a = 0; a < 2; ++a)
#pragma unroll
        for (int b = 0; b < 2; ++b)
#pragma unroll
            for (int m = 0; m < 4; ++m)
#pragma unroll
                for (int n = 0; n < 2; ++n) acc[a][b][m][n] = (f32x4){0.f, 0.f, 0.f, 0.f};
    bf16x8 At[4][2], B0[2][2], B1[2][2];
    const char* cA = (const char*)g.A + (size_t)cur.pm * tstep; const char* cB = (const char*)g.Bt + (size_t)cur.pn * tstep;
    S.a_ready(cur);
    if constexpr (SP2) {
        PG8_STAGE(PG8_SB(0, 0), cB, voffB); PG8_STAGE(PG8_SB(0, 1), cB + hstep, voffB); PG8_STAGE(PG8_SA(0, 0), cA, voffA); PG8_STAGE(PG8_SA(0, 1), cA + hstep, voffA);
        if (wr == 1) PG8_BAR;
        PG8_WAIT_V(2); PG8_BAR;
        PG8_STAGE(PG8_SB(1, 0), cB + kstep, voffB); PG8_STAGE(PG8_SA(1, 0), cA + kstep, voffA); PG8_STAGE(PG8_SB(1, 1), cB + hstep + kstep, voffB);
        PG8_WAIT_V(6); PG8_BAR;
    } else {
        PG8_STAGE(PG8_SB(0, 0), cB, voffB); PG8_STAGE(PG8_SA(0, 0), cA, voffA); PG8_STAGE(PG8_SB(0, 1), cB + hstep, voffB); PG8_STAGE(PG8_SA(0, 1), cA + hstep, voffA);
        if (wr == 1) PG8_BAR;
        PG8_WAIT_V(4); PG8_BAR;
        PG8_STAGE(PG8_SB(1, 0), cB + kstep, voffB); PG8_STAGE(PG8_SA(1, 0), cA + kstep, voffA); PG8_STAGE(PG8_SB(1, 1), cB + hstep + kstep, voffB);
        PG8_WAIT_V(6); PG8_BAR;
    }
    for (;;) {
        const bool has_next = S.next(ui + 1, nxt);
        const char* nA = has_next ? (const char*)g.A + (size_t)nxt.pm * tstep : cA; const char* nB = has_next ? (const char*)g.Bt + (size_t)nxt.pn * tstep : cB;
        for (int t = 0; t < nt; t += 2) {
            const bool last = (t == nt - 2);
            const char* a1 = cA + (size_t)(t + 1) * kstep;
            const char* a2 = last ? nA : cA + (size_t)(t + 2) * kstep; const char* b2 = last ? nB : cB + (size_t)(t + 2) * kstep;
            const char* a3 = a2 + kstep; const char* b3 = b2 + kstep;
            if (last && has_next) S.a_ready(nxt);
            if constexpr (SP2) {
            PG8_LDB(B0, 0, 0); PG8_LDB(B1, 0, 1); PG8_SCHED; PG8_LDA(At, 0, 0); PG8_STAGE(PG8_SA(1, 1), a1 + hstep, voffA);
            PG8_WAIT_V(8); PG8_WAIT_L(0); PG8_BAR; PG8_MMA(0, 0, At, B0); PG8_MMA(0, 1, At, B1); PG8_BAR; PG8_SCHED;
            PG8_LDA(At, 0, 1); PG8_STAGE(PG8_SB(0, 0), b2, voffB); PG8_STAGE(PG8_SB(0, 1), b2 + hstep, voffB); PG8_STAGE(PG8_SA(0, 0), a2, voffA);
            PG8_WAIT_V(8); PG8_WAIT_L(0); PG8_BAR; PG8_MMA(1, 0, At, B0); PG8_MMA(1, 1, At, B1); PG8_BAR; PG8_SCHED;
            PG8_LDB(B0, 1, 0); PG8_LDB(B1, 1, 1); PG8_SCHED; PG8_LDA(At, 1, 0); PG8_STAGE(PG8_SA(0, 1), a2 + hstep, voffA);
            PG8_WAIT_V(8); PG8_WAIT_L(0); PG8_BAR; PG8_MMA(0, 0, At, B0); PG8_MMA(0, 1, At, B1); PG8_BAR; PG8_SCHED;
            PG8_LDA(At, 1, 1); PG8_STAGE(PG8_SB(1, 0), b3, voffB); PG8_STAGE(PG8_SB(1, 1), b3 + hstep, voffB); PG8_STAGE(PG8_SA(1, 0), a3, voffA);
            PG8_WAIT_V(8); PG8_WAIT_L(0); PG8_BAR; PG8_MMA(1, 0, At, B0); PG8_MMA(1, 1, At, B1); PG8_BAR; PG8_SCHED;
            } else {
            PG8_LDB(B0, 0, 0); PG8_SCHED; PG8_LDA(At, 0, 0); PG8_STAGE(PG8_SA(1, 1), a1 + hstep, voffA);
            PG8_WAIT_L(8); PG8_BAR; PG8_WAIT_L(0); PG8_MMA(0, 0, At, B0); PG8_BAR; PG8_SCHED;
            PG8_LDB(B1, 0, 1); PG8_STAGE(PG8_SB(0, 0), b2, voffB);
            PG8_BAR; PG8_WAIT_L(0); PG8_MMA(0, 1, At, B1); PG8_BAR;
            PG8_LDA(At, 0, 1); PG8_STAGE(PG8_SA(0, 0), a2, voffA);
            PG8_BAR; PG8_WAIT_L(0); PG8_MMA(1, 0, At, B0); PG8_BAR; PG8_SCHED;
            PG8_STAGE(PG8_SB(0, 1), b2 + hstep, voffB);
            PG8_WAIT_V(6); PG8_BAR; PG8_MMA(1, 1, At, B1); PG8_BAR;
            PG8_LDB(B0, 1, 0); PG8_SCHED; PG8_LDA(At, 1, 0); PG8_STAGE(PG8_SA(0, 1), a2 + hstep, voffA);
            PG8_WAIT_L(8); PG8_BAR; PG8_WAIT_L(0); PG8_MMA(0, 0, At, B0); PG8_BAR; PG8_SCHED;
            PG8_LDB(B1, 1, 1); PG8_STAGE(PG8_SB(1, 0), b3, voffB);
            PG8_BAR; PG8_WAIT_L(0); PG8_MMA(0, 1, At, B1); PG8_BAR;
            PG8_LDA(At, 1, 1); PG8_STAGE(PG8_SA(1, 0), a3, voffA);
            PG8_BAR; PG8_WAIT_L(0); PG8_MMA(1, 0, At, B0); PG8_BAR; PG8_SCHED;
            PG8_STAGE(PG8_SB(1, 1), b3 + hstep, voffB);
            PG8_WAIT_V(6); PG8_BAR; PG8_MMA(1, 1, At, B1); PG8_BAR;
            }
        }
        if constexpr (ALIGN_EPI) { if (wr == 0) PG8_BAR; }
        if constexpr (!Epi::AFTER_DRAIN) { E(acc, cur, wr, wc, fr, fq); S.done(cur); }
        if (!has_next) break;
#pragma unroll
        for (int a = 0; a < 2; ++a)
#pragma unroll
            for (int b = 0; b < 2; ++b)
#pragma unroll
                for (int m = 0; m < 4; ++m)
#pragma unroll
                    for (int n = 0; n < 2; ++n) acc[a][b][m][n] = (f32x4){0.f, 0.f, 0.f, 0.f};
        cur = nxt; cA = nA; cB = nB; ++ui;
        if constexpr (ALIGN_EPI) { if (wr == 1) PG8_BAR; }
    }
    PG8_WAIT_V(0);
    if constexpr (!ALIGN_EPI) { if (wr == 0) PG8_BAR; }
    PG8_BAR;
    if constexpr (Epi::AFTER_DRAIN) { E.fused(acc, cur, wr, wc, fr, fq, lds, wid, lane); S.done(cur); }
#undef PG8_SA
#undef PG8_SB
#undef PG8_STAGE
#undef PG8_LDA
#undef PG8_LDB
#undef PG8_MMA
#undef PG8_WAIT_V
#undef PG8_WAIT_L
#undef PG8_BAR
#undef PG8_SCHED
}
}

constexpr int NWAVES = 8;
constexpr int N_LAUNCHES = MK_N_LAUNCHES;
constexpr int N_PHASES = 8;
constexpr int D = 1024, SEQ = 4096, NSEQ_P = 16, NSEQ = 24, T = NSEQ * SEQ;
constexpr int DL = 512, HD = 64, NH = 8, NPROJ = 1536, FF = 2816, NGU = 2 * FF;
constexpr float EPS = 1e-6f;
constexpr size_t MiB = 1u << 20;
constexpr size_t WS_CTL = 0, CTL_ZERO_BYTES = 4096;
constexpr size_t WS_WIN = 2 * MiB, WS_WOUT = 5 * MiB, WS_WGU = 7 * MiB, WS_WD = 18 * MiB, WS_PW = 24 * MiB;
constexpr size_t WS_R1 = 32 * MiB;
constexpr size_t WS_PROJ = 224 * MiB;
constexpr size_t WS_HBUF = 512 * MiB;
constexpr size_t WS_M = 704 * MiB;
constexpr size_t WS_ACT = 32 * MiB;
constexpr size_t WS_END = 896 * MiB;
static_assert(WS_ACT + (size_t)T * FF * 2 <= WS_M && WS_M + (size_t)T * D * 2 <= WS_END, "ws map");
constexpr int CW_POOLQ = 64;
constexpr int RING_BYTES = 131072, MISC_OFF = RING_BYTES, LDS_BYTES = 147456;

#define GAS __attribute__((address_space(1)))
#define LAS __attribute__((address_space(3)))
typedef unsigned short bf16;
typedef unsigned v4u __attribute__((ext_vector_type(4)));
typedef float f32x4 __attribute__((ext_vector_type(4)));
typedef short bf16x8 __attribute__((ext_vector_type(8)));
#define LDS_WAIT() asm volatile("s_waitcnt lgkmcnt(0)" ::: "memory")
#define VM_WAIT() asm volatile("s_waitcnt vmcnt(0)" ::: "memory")
__device__ __forceinline__ unsigned f2bf(float f) { unsigned u = __builtin_bit_cast(unsigned, f); return (u + 0x7fffu + ((u >> 16) & 1u)) >> 16; }
__device__ __forceinline__ unsigned pk2(float lo, float hi) { return pg8::cvt_pk_bf16(lo, hi); }
__device__ __forceinline__ float bf_lo(unsigned w) { return __builtin_bit_cast(float, w << 16); }
__device__ __forceinline__ float bf_hi(unsigned w) { return __builtin_bit_cast(float, w & 0xffff0000u); }
__device__ __forceinline__ float wave_sum(float v) {
#pragma unroll
    for (int o = 1; o < 64; o <<= 1) v += __shfl_xor(v, o);
    return v;
}

struct Args { const float* in[21]; float* out; unsigned char* ws; int ph_lo, ph_hi; };

__device__ __forceinline__ void p0_transpose_item(const float* W, int K, int N, bf16* WT, int k0, int n0, int drow0, LAS float* scr, int lane) {
#pragma unroll 8
    for (int i = 0; i < 32; ++i) { const int kk = 2 * i + (lane >> 5); scr[kk * 33 + (lane & 31)] = W[(size_t)(k0 + kk) * N + n0 + (lane & 31)]; }
    LDS_WAIT(); asm volatile("" ::: "memory");
    const int c = lane & 7;
#pragma unroll
    for (int j = 0; j < 4; ++j) { const int n = (lane >> 3) + 8 * j; const LAS float* s = scr + (8 * c) * 33 + n;
        v4u o; o.x = pk2(s[0 * 33], s[1 * 33]); o.y = pk2(s[2 * 33], s[3 * 33]); o.z = pk2(s[4 * 33], s[5 * 33]); o.w = pk2(s[6 * 33], s[7 * 33]);
        *(GAS v4u*)(WT + (size_t)(drow0 + n) * K + k0 + 8 * c) = o; }
    LDS_WAIT(); asm volatile("" ::: "memory");
}
__device__ __forceinline__ const float* xrow_ptr(const Args& a, int m) { return m < NSEQ_P * SEQ ? a.in[0] + (size_t)m * D : a.in[1] + (size_t)(m - NSEQ_P * SEQ) * D; }

__device__ __forceinline__ void phase_prep(const Args& a, LAS unsigned char* lds, int wave, int lane) {
    LAS float* scr = (LAS float*)(lds + wave * 16384);
    const int gw = blockIdx.x * NWAVES + wave, NGW = gridDim.x * NWAVES;
    unsigned char* ws = a.ws;
    constexpr int I_IN = (D / 64) * (NPROJ / 32), I_OUT = (D / 64) * (D / 32), I_G = (D / 64) * (FF / 32), I_D = (FF / 64) * (D / 32), I_P = 4 * 2 * 4;
    constexpr int NITEMS = I_IN + I_OUT + 2 * I_G + I_D + I_P;
    for (int it = gw; it < NITEMS; it += NGW) {
        int r = it;
        if (r < I_IN) { const int nb = NPROJ / 32; p0_transpose_item(a.in[4], D, NPROJ, (bf16*)(ws + WS_WIN), 64 * (r / nb), 32 * (r % nb), 32 * (r % nb), scr, lane); continue; } r -= I_IN;
        if (r < I_OUT) { const int nb = D / 32; p0_transpose_item(a.in[15], D, D, (bf16*)(ws + WS_WOUT), 64 * (r / nb), 32 * (r % nb), 32 * (r % nb), scr, lane); continue; } r -= I_OUT;
        if (r < 2 * I_G) { const int up = r >= I_G; if (up) r -= I_G; const int nb = FF / 32, n0 = 32 * (r % nb);
            p0_transpose_item(a.in[up ? 19 : 18], D, FF, (bf16*)(ws + WS_WGU), 64 * (r / nb), n0, (n0 >> 7) * 256 + (n0 & 127) + (up ? 128 : 0), scr, lane); continue; } r -= 2 * I_G;
        if (r < I_D) { const int nb = D / 32; p0_transpose_item(a.in[20], FF, D, (bf16*)(ws + WS_WD), 64 * (r / nb), 32 * (r % nb), 32 * (r % nb), scr, lane); continue; } r -= I_D;
        { const int g = r >> 3, q = r & 7; p0_transpose_item(a.in[12] + (size_t)g * 128 * 128, 128, 128, (bf16*)(ws + WS_PW) + (size_t)g * 128 * 128, 64 * (q >> 2), 32 * (q & 3), 32 * (q & 3), scr, lane); }
    }
    const float* gn = a.in[2];
    f32x4 gv[4];
#pragma unroll
    for (int j = 0; j < 4; ++j) gv[j] = *(const f32x4*)(gn + 4 * lane + 256 * j);
    bf16* H1 = (bf16*)(ws + WS_R1);
    for (int m = gw; m < T; m += NGW) {
        const GAS f32x4* xr = (const GAS f32x4*)xrow_ptr(a, m) + lane;
        f32x4 v[4]; float s = 0.f;
#pragma unroll
        for (int j = 0; j < 4; ++j) { v[j] = xr[64 * j]; s += (v[j].x * v[j].x + v[j].y * v[j].y) + (v[j].z * v[j].z + v[j].w * v[j].w); }
        const float rs = __builtin_amdgcn_rsqf(wave_sum(s) * (1.f / D) + EPS);
        GAS unsigned long long* o8 = (GAS unsigned long long*)(H1 + (size_t)m * D) + lane;
#pragma unroll
        for (int j = 0; j < 4; ++j) { const f32x4 y = v[j] * rs * gv[j]; o8[64 * j] = (unsigned long long)pk2(y.x, y.y) | ((unsigned long long)pk2(y.z, y.w) << 32); }
    }
}

__device__ __forceinline__ void phase_mid_norm(const Args& a, int wave, int lane) {
    const int gw = blockIdx.x * NWAVES + wave, NGW = gridDim.x * NWAVES;
    const float* g1 = a.in[3]; const float* g2 = a.in[16];
    bf16* MB = (bf16*)(a.ws + WS_M);
    for (int m = gw; m < T; m += NGW) {
        const GAS v4u* mr = (const GAS v4u*)(MB + (size_t)m * D);
        const float* xr = xrow_ptr(a, m); float* orow = a.out + (size_t)m * D;
        float mv[16], xv[16]; float s = 0.f;
#pragma unroll
        for (int h = 0; h < 2; ++h) { const v4u w = mr[lane + 64 * h]; const unsigned ww[4] = {w.x, w.y, w.z, w.w};
#pragma unroll
            for (int q = 0; q < 4; ++q) { mv[8 * h + 2 * q] = bf_lo(ww[q]); mv[8 * h + 2 * q + 1] = bf_hi(ww[q]); }
            const f32x4 x0 = *(const GAS f32x4*)(xr + 512 * h + 8 * lane), x1 = *(const GAS f32x4*)(xr + 512 * h + 8 * lane + 4);
            xv[8 * h + 0] = x0.x; xv[8 * h + 1] = x0.y; xv[8 * h + 2] = x0.z; xv[8 * h + 3] = x0.w; xv[8 * h + 4] = x1.x; xv[8 * h + 5] = x1.y; xv[8 * h + 6] = x1.z; xv[8 * h + 7] = x1.w; }
#pragma unroll
        for (int i = 0; i < 16; ++i) s += mv[i] * mv[i];
        const float rs1 = __builtin_amdgcn_rsqf(wave_sum(s) * (1.f / D) + EPS);
        float s2 = 0.f;
#pragma unroll
        for (int h = 0; h < 2; ++h) { const f32x4 ga = *(const f32x4*)(g1 + 512 * h + 8 * lane), gb = *(const f32x4*)(g1 + 512 * h + 8 * lane + 4);
            const float gg[8] = {ga.x, ga.y, ga.z, ga.w, gb.x, gb.y, gb.z, gb.w};
#pragma unroll
            for (int i = 0; i < 8; ++i) { const float v = xv[8 * h + i] + mv[8 * h + i] * rs1 * gg[i]; xv[8 * h + i] = v; s2 += v * v; } }
        const float rs2 = __builtin_amdgcn_rsqf(wave_sum(s2) * (1.f / D) + EPS);
#pragma unroll
        for (int h = 0; h < 2; ++h) {
            *(GAS f32x4*)(orow + 512 * h + 8 * lane) = (f32x4){xv[8 * h], xv[8 * h + 1], xv[8 * h + 2], xv[8 * h + 3]};
            *(GAS f32x4*)(orow + 512 * h + 8 * lane + 4) = (f32x4){xv[8 * h + 4], xv[8 * h + 5], xv[8 * h + 6], xv[8 * h + 7]};
            const f32x4 ga = *(const f32x4*)(g2 + 512 * h + 8 * lane), gb = *(const f32x4*)(g2 + 512 * h + 8 * lane + 4);
            v4u o; o.x = pk2(xv[8 * h] * rs2 * ga.x, xv[8 * h + 1] * rs2 * ga.y); o.y = pk2(xv[8 * h + 2] * rs2 * ga.z, xv[8 * h + 3] * rs2 * ga.w);
            o.z = pk2(xv[8 * h + 4] * rs2 * gb.x, xv[8 * h + 5] * rs2 * gb.y); o.w = pk2(xv[8 * h + 6] * rs2 * gb.z, xv[8 * h + 7] * rs2 * gb.w);
            *(GAS v4u*)(MB + (size_t)m * D + 512 * h + 8 * lane) = o; }
    }
}
__device__ __forceinline__ void phase_final_norm(const Args& a, int wave, int lane) {
    const int gw = blockIdx.x * NWAVES + wave, NGW = gridDim.x * NWAVES;
    const float* g4 = a.in[17];
    const bf16* FB = (const bf16*)(a.ws + WS_M);
    for (int m = gw; m < T; m += NGW) {
        const GAS v4u* fr_ = (const GAS v4u*)(FB + (size_t)m * D);
        float* orow = a.out + (size_t)m * D;
        float fv[16]; float s = 0.f;
#pragma unroll
        for (int h = 0; h < 2; ++h) { const v4u w = fr_[lane + 64 * h]; const unsigned ww[4] = {w.x, w.y, w.z, w.w};
#pragma unroll
            for (int q = 0; q < 4; ++q) { fv[8 * h + 2 * q] = bf_lo(ww[q]); fv[8 * h + 2 * q + 1] = bf_hi(ww[q]); } }
#pragma unroll
        for (int i = 0; i < 16; ++i) s += fv[i] * fv[i];
        const float rs = __builtin_amdgcn_rsqf(wave_sum(s) * (1.f / D) + EPS);
#pragma unroll
        for (int h = 0; h < 2; ++h) {
            const f32x4 ga = *(const f32x4*)(g4 + 512 * h + 8 * lane), gb = *(const f32x4*)(g4 + 512 * h + 8 * lane + 4);
            f32x4 x0 = *(const GAS f32x4*)(orow + 512 * h + 8 * lane), x1 = *(const GAS f32x4*)(orow + 512 * h + 8 * lane + 4);
            x0.x += fv[8 * h] * rs * ga.x; x0.y += fv[8 * h + 1] * rs * ga.y; x0.z += fv[8 * h + 2] * rs * ga.z; x0.w += fv[8 * h + 3] * rs * ga.w;
            x1.x += fv[8 * h + 4] * rs * gb.x; x1.y += fv[8 * h + 5] * rs * gb.y; x1.z += fv[8 * h + 6] * rs * gb.z; x1.w += fv[8 * h + 7] * rs * gb.w;
            *(GAS f32x4*)(orow + 512 * h + 8 * lane) = x0; *(GAS f32x4*)(orow + 512 * h + 8 * lane + 4) = x1; }
    }
}

namespace mix {
constexpr int UB_STRIDE = 72;
constexpr int UF_STRIDE = 68;
constexpr int UB_BYTES = 64 * UB_STRIDE * 2;
constexpr int UF_BYTES = 64 * UF_STRIDE * 4;
constexpr int HALF_BYTES = UB_BYTES + 2 * UF_BYTES;
constexpr int CW_OFF = 2 * HALF_BYTES;
constexpr int RAW_STRIDE = 272;
constexpr int RAW_ROWS = 256 + 15;
static_assert(CW_OFF + 320 * 4 <= RING_BYTES && RAW_ROWS * RAW_STRIDE <= RING_BYTES, "mixer LDS");

__device__ __forceinline__ float sigmoidf_fast(float x) { return __builtin_amdgcn_rcpf(1.0f + __builtin_amdgcn_exp2f(x * -1.44269504089f)); }

__device__ __forceinline__ void lru_load_raw(const bf16* proj, int seq, int col, int tok, v4u (&raw)[4][2]) {
#pragma unroll
    for (int k = 0; k < 4; ++k) { const int tk = tok + k - 2; const bool ok = (unsigned)tk < (unsigned)SEQ;
        const GAS v4u* p = (const GAS v4u*)(proj + (size_t)(seq * SEQ + (ok ? tk : tok)) * NPROJ + col);
        v4u a = p[0], b = p[1]; if (!ok) { a = (v4u){0u, 0u, 0u, 0u}; b = a; } raw[k][0] = a; raw[k][1] = b; }
}

__device__ __forceinline__ void lru_unit(const Args& a, LAS unsigned char* lds, int seq, int hd, int tid, int wave, int lane) {
    const int fr = lane & 15, fq = lane >> 4;
    const int dir = wave >> 2, cc0 = (wave & 3) * 16;
    const int ht = tid & 255, r = ht >> 2, cs = ht & 3;
    LAS unsigned char* hb = lds + dir * HALF_BYTES;
    LAS bf16* Ub = (LAS bf16*)hb; LAS float* Uf = (LAS float*)(hb + UB_BYTES); LAS float* Ot = (LAS float*)(hb + UB_BYTES + UF_BYTES);
    LAS float* CW = (LAS float*)(lds + CW_OFF);
    const bf16* proj = (const bf16*)(a.ws + WS_PROJ); bf16* ycat = (bf16*)(a.ws + WS_R1); float* hbuf = (float*)(a.ws + WS_HBUF);
    __syncthreads();
    if (tid < 256) CW[tid] = a.in[5][(tid >> 6) * DL + hd * HD + (tid & 63)]; else if (tid < 320) CW[tid] = a.in[6][hd * HD + (tid & 63)];
    bf16x8 Ba[2], Bx[2];
    { const float* wa = a.in[7] + (size_t)(dir * NH + hd) * HD * HD + cc0 + fr; const float* wx = a.in[9] + (size_t)(dir * NH + hd) * HD * HD + cc0 + fr;
#pragma unroll
      for (int ks = 0; ks < 2; ++ks)
#pragma unroll
        for (int j = 0; j < 8; ++j) { const int k = ks * 32 + 8 * fq + j; Ba[ks][j] = (short)f2bf(wa[k * HD]); Bx[ks][j] = (short)f2bf(wx[k * HD]); } }
    const int ch = hd * HD + cc0 + fr;
    const float ba = a.in[8][dir * DL + ch], bx = a.in[10][dir * DL + ch];
    const float k2 = -8.0f * log1pf(expf(-a.in[11][dir * DL + ch])) * 1.44269504089f;
    float hcarry = 0.f;
    const int ucol = hd * HD + cs * 16;
    v4u raw[4][2];
    { const int j0 = dir ? 63 : 0; lru_load_raw(proj, seq, ucol, j0 * 64 + (dir ? 63 - r : r), raw); }
    __syncthreads();
    for (int s = 0; s < 64; ++s) {
        const int j = dir ? 63 - s : s;
        const int tok = j * 64 + (dir ? 63 - r : r);
        const size_t gt = (size_t)seq * SEQ + tok;
        {
            float u[16];
#pragma unroll
            for (int q = 0; q < 4; ++q) { const f32x4 b4 = *(const LAS f32x4*)(CW + 256 + cs * 16 + 4 * q); u[4 * q] = b4.x; u[4 * q + 1] = b4.y; u[4 * q + 2] = b4.z; u[4 * q + 3] = b4.w; }
#pragma unroll
            for (int k = 0; k < 4; ++k) {
                const unsigned ww[8] = {raw[k][0].x, raw[k][0].y, raw[k][0].z, raw[k][0].w, raw[k][1].x, raw[k][1].y, raw[k][1].z, raw[k][1].w};
#pragma unroll
                for (int q = 0; q < 4; ++q) { const f32x4 w4 = *(const LAS f32x4*)(CW + k * 64 + cs * 16 + 4 * q);
                    u[4 * q] += w4.x * bf_lo(ww[2 * q]); u[4 * q + 1] += w4.y * bf_hi(ww[2 * q]); u[4 * q + 2] += w4.z * bf_lo(ww[2 * q + 1]); u[4 * q + 3] += w4.w * bf_hi(ww[2 * q + 1]); }
            }
#pragma unroll
            for (int q = 0; q < 4; ++q) *(LAS f32x4*)(Uf + r * UF_STRIDE + cs * 16 + 4 * q) = (f32x4){u[4 * q], u[4 * q + 1], u[4 * q + 2], u[4 * q + 3]};
            v4u p0, p1; p0.x = pk2(u[0], u[1]); p0.y = pk2(u[2], u[3]); p0.z = pk2(u[4], u[5]); p0.w = pk2(u[6], u[7]); p1.x = pk2(u[8], u[9]); p1.y = pk2(u[10], u[11]); p1.z = pk2(u[12], u[13]); p1.w = pk2(u[14], u[15]);
            *(LAS v4u*)(Ub + r * UB_STRIDE + cs * 16) = p0; *(LAS v4u*)(Ub + r * UB_STRIDE + cs * 16 + 8) = p1;
        }
        VM_WAIT();
        __syncthreads();
        const bool fin = s >= 32;
        if (s < 63) { const int jn = dir ? 62 - s : s + 1; lru_load_raw(proj, seq, ucol, jn * 64 + (dir ? 63 - r : r), raw); }
        f32x4 ho[4]; v4u gt2[2];
#pragma unroll
        for (int q = 0; q < 4; ++q) ho[q] = (f32x4){0.f, 0.f, 0.f, 0.f};
        gt2[0] = (v4u){0u, 0u, 0u, 0u}; gt2[1] = gt2[0];
        if (fin) {
#pragma unroll
            for (int q = 0; q < 4; ++q) ho[q] = *(const GAS f32x4*)(hbuf + gt * DL + ucol + 4 * q);
            gt2[0] = *(const GAS v4u*)(proj + gt * NPROJ + DL + ucol); gt2[1] = *(const GAS v4u*)(proj + gt * NPROJ + DL + ucol + 8);
        }
        {
            f32x4 racc[4], iacc[4];
#pragma unroll
            for (int tt = 0; tt < 4; ++tt) { racc[tt] = (f32x4){ba, ba, ba, ba}; iacc[tt] = (f32x4){bx, bx, bx, bx}; }
#pragma unroll
            for (int tt = 0; tt < 4; ++tt)
#pragma unroll
                for (int ks = 0; ks < 2; ++ks) { const bf16x8 af = *(const LAS bf16x8*)(Ub + (tt * 16 + fr) * UB_STRIDE + ks * 32 + fq * 8);
                    racc[tt] = __builtin_amdgcn_mfma_f32_16x16x32_bf16(af, Ba[ks], racc[tt], 0, 0, 0);
                    iacc[tt] = __builtin_amdgcn_mfma_f32_16x16x32_bf16(af, Bx[ks], iacc[tt], 0, 0, 0); }
            float PA[4][4], PB[4][4], EA[4], EB[4], GA[4], GB[4];
#pragma unroll
            for (int tt = 0; tt < 4; ++tt) {
                float av[4], bv[4];
#pragma unroll
                for (int g = 0; g < 4; ++g) {
                    const float uu = Uf[(tt * 16 + 4 * fq + g) * UF_STRIDE + cc0 + fr];
                    const float rr = sigmoidf_fast(racc[tt][g]), ii = sigmoidf_fast(iacc[tt][g]);
                    const float aa = __builtin_amdgcn_exp2f(rr * k2);
                    const float mult = __builtin_amdgcn_sqrtf(fmaxf(1.0f - aa * aa, 0.0f));
                    av[g] = aa; bv[g] = mult * ii * uu;
                }
                PA[tt][0] = av[0]; PB[tt][0] = bv[0];
#pragma unroll
                for (int g = 1; g < 4; ++g) { PA[tt][g] = av[g] * PA[tt][g - 1]; PB[tt][g] = av[g] * PB[tt][g - 1] + bv[g]; }
                float IA = PA[tt][3], IB = PB[tt][3];
                float pA = __shfl_up(IA, 16), pB = __shfl_up(IB, 16); if (fq >= 1) { IB = IA * pB + IB; IA = IA * pA; }
                pA = __shfl_up(IA, 32); pB = __shfl_up(IB, 32); if (fq >= 2) { IB = IA * pB + IB; IA = IA * pA; }
                GA[tt] = __shfl(IA, 48 + fr); GB[tt] = __shfl(IB, 48 + fr);
                pA = __shfl_up(IA, 16); pB = __shfl_up(IB, 16); EA[tt] = fq ? pA : 1.0f; EB[tt] = fq ? pB : 0.0f;
            }
            float hin = hcarry;
#pragma unroll
            for (int tt = 0; tt < 4; ++tt) { const float hs = EA[tt] * hin + EB[tt]; hin = GA[tt] * hin + GB[tt];
#pragma unroll
                for (int g = 0; g < 4; ++g) Ot[(tt * 16 + 4 * fq + g) * UF_STRIDE + cc0 + fr] = PA[tt][g] * hs + PB[tt][g]; }
            hcarry = hin;
        }
        __syncthreads();
        {
            f32x4 hv[4];
#pragma unroll
            for (int q = 0; q < 4; ++q) hv[q] = *(const LAS f32x4*)(Ot + r * UF_STRIDE + cs * 16 + 4 * q);
            if (!fin) {
#pragma unroll
                for (int q = 0; q < 4; ++q) *(GAS f32x4*)(hbuf + gt * DL + ucol + 4 * q) = hv[q];
            } else {
                const unsigned gw[8] = {gt2[0].x, gt2[0].y, gt2[0].z, gt2[0].w, gt2[1].x, gt2[1].y, gt2[1].z, gt2[1].w};
                float y[16];
#pragma unroll
                for (int q = 0; q < 4; ++q) {
                    const float hh[4] = {hv[q].x + ho[q].x, hv[q].y + ho[q].y, hv[q].z + ho[q].z, hv[q].w + ho[q].w};
                    const float gg[4] = {bf_lo(gw[2 * q]), bf_hi(gw[2 * q]), bf_lo(gw[2 * q + 1]), bf_hi(gw[2 * q + 1])};
#pragma unroll
                    for (int e = 0; e < 4; ++e) { const float x = gg[e]; const float z = 1.5957691216f * (x + 0.044715f * x * x * x);
                        y[4 * q + e] = hh[e] * x * sigmoidf_fast(z); }
                }
                v4u p0, p1; p0.x = pk2(y[0], y[1]); p0.y = pk2(y[2], y[3]); p0.z = pk2(y[4], y[5]); p0.w = pk2(y[6], y[7]); p1.x = pk2(y[8], y[9]); p1.y = pk2(y[10], y[11]); p1.z = pk2(y[12], y[13]); p1.w = pk2(y[14], y[15]);
                *(GAS v4u*)(ycat + gt * D + ucol) = p0; *(GAS v4u*)(ycat + gt * D + ucol + 8) = p1;
            }
        }
    }
}

__device__ __forceinline__ void pool_unit(const Args& a, LAS unsigned char* lds, int unit, int tid, int wave, int lane) {
    const int fr = lane & 15, fq = lane >> 4;
    const int tile = unit >> 2, g = unit & 3, w = 2 << g, half = w >> 1;
    const int seq = tile >> 4, tin0 = (tile & 15) * 256;
    const bf16* proj = (const bf16*)(a.ws + WS_PROJ); bf16* ycat = (bf16*)(a.ws + WS_R1);
    const int pcol = 2 * DL + g * 128;
    for (int idx = tid; idx < RAW_ROWS * 16; idx += NWAVES * 64) { const int rr = idx >> 4, pc = idx & 15; const int tk = tin0 - 8 + rr; const bool ok = (unsigned)tk < (unsigned)SEQ;
        v4u v = *(const GAS v4u*)(proj + (size_t)(seq * SEQ + (ok ? tk : tin0)) * NPROJ + pcol + pc * 8); if (!ok) v = (v4u){0u, 0u, 0u, 0u};
        *(LAS v4u*)(lds + rr * RAW_STRIDE + pc * 16) = v; }
    __syncthreads();
    bf16x8 Af[2][4];
#pragma unroll
    for (int mt = 0; mt < 2; ++mt) {
        const int row = wave * 32 + mt * 16 + fr, tin = tin0 + row;
        const int lo = max(tin - half, 0), hi = min(tin + w - half, SEQ);
        const float inv = 1.0f / (float)(hi - lo);
#pragma unroll
        for (int ks = 0; ks < 4; ++ks) {
            const LAS unsigned char* base = lds + (row + 8) * RAW_STRIDE + (ks * 32 + fq * 8) * 2;
            float sum[8];
#pragma unroll
            for (int e = 0; e < 8; ++e) sum[e] = 0.f;
            for (int off = -half; off < half; ++off) { const v4u v = *(const LAS v4u*)(base + off * RAW_STRIDE);
                sum[0] += bf_lo(v.x); sum[1] += bf_hi(v.x); sum[2] += bf_lo(v.y); sum[3] += bf_hi(v.y); sum[4] += bf_lo(v.z); sum[5] += bf_hi(v.z); sum[6] += bf_lo(v.w); sum[7] += bf_hi(v.w); }
            const v4u o = *(const LAS v4u*)base;
            v4u p; p.x = pk2(sum[0] * inv - bf_lo(o.x), sum[1] * inv - bf_hi(o.x)); p.y = pk2(sum[2] * inv - bf_lo(o.y), sum[3] * inv - bf_hi(o.y));
            p.z = pk2(sum[4] * inv - bf_lo(o.z), sum[5] * inv - bf_hi(o.z)); p.w = pk2(sum[6] * inv - bf_lo(o.w), sum[7] * inv - bf_hi(o.w));
            Af[mt][ks] = __builtin_bit_cast(bf16x8, p);
        }
    }
    const bf16* pw = (const bf16*)(a.ws + WS_PW) + (size_t)g * 128 * 128;
    f32x4 acc[2][8];
#pragma unroll
    for (int nt = 0; nt < 8; ++nt) { const f32x4 b4 = *(const f32x4*)(a.in[13] + g * 128 + 32 * fq + 4 * nt); acc[0][nt] = b4; acc[1][nt] = b4; }
#pragma unroll
    for (int nt = 0; nt < 8; ++nt) {
        const int n = 32 * (fr >> 2) + 4 * nt + (fr & 3);
        bf16x8 bf[4];
#pragma unroll
        for (int ks = 0; ks < 4; ++ks) bf[ks] = *(const GAS bf16x8*)(pw + (size_t)n * 128 + ks * 32 + fq * 8);
#pragma unroll
        for (int ks = 0; ks < 4; ++ks) { acc[0][nt] = __builtin_amdgcn_mfma_f32_16x16x32_bf16(bf[ks], Af[0][ks], acc[0][nt], 0, 0, 0);
                                         acc[1][nt] = __builtin_amdgcn_mfma_f32_16x16x32_bf16(bf[ks], Af[1][ks], acc[1][nt], 0, 0, 0); }
    }
#pragma unroll
    for (int mt = 0; mt < 2; ++mt) {
        const size_t gt = (size_t)seq * SEQ + tin0 + wave * 32 + mt * 16 + fr;
        bf16* orow = ycat + gt * D + DL + g * 128 + 32 * fq;
#pragma unroll
        for (int q = 0; q < 4; ++q) {
            const f32x4 s0 = *(const f32x4*)(a.in[14] + g * 128 + 32 * fq + 8 * q), s1 = *(const f32x4*)(a.in[14] + g * 128 + 32 * fq + 8 * q + 4);
            const f32x4 v0 = acc[mt][2 * q] * s0, v1 = acc[mt][2 * q + 1] * s1;
            v4u p; p.x = pk2(v0.x, v0.y); p.y = pk2(v0.z, v0.w); p.z = pk2(v1.x, v1.y); p.w = pk2(v1.z, v1.w);
            *(GAS v4u*)(orow + 8 * q) = p; }
    }
    __syncthreads();
}

__device__ __forceinline__ void phase_mixer(const Args& a, LAS unsigned char* lds, int tid, int wave, int lane) {
    for (int u = blockIdx.x; u < NSEQ * NH; u += gridDim.x) lru_unit(a, lds, u >> 3, u & 7, tid, wave, lane);
    volatile LAS unsigned* misc = (volatile LAS unsigned*)(lds + MISC_OFF);
    unsigned* q = (unsigned*)(a.ws + WS_CTL) + CW_POOLQ;
    for (;;) {
        __syncthreads();
        if (tid == 0) misc[0] = atomicAdd(q, 1u);
        __syncthreads();
        const unsigned u = misc[0];
        if (u >= (unsigned)(T / 256 * 4)) break;
        pool_unit(a, lds, (int)u, tid, wave, lane);
    }
}
}

__global__ void __launch_bounds__(NWAVES * 64, 2) hymba_fwd(Args args) {
    extern __shared__ __attribute__((aligned(16))) unsigned char lds_raw[];
    LAS unsigned char* lds = (LAS unsigned char*)lds_raw;
    const int tid = threadIdx.x, lane = tid & 63, wave = __builtin_amdgcn_readfirstlane(tid >> 6);
    const int G = gridDim.x;
    const int lo = args.ph_lo, hi = args.ph_hi;
    unsigned char* ws = args.ws;
#define IN(k) (lo <= (k) && (k) < hi)
#define GRID_BAR(k) do { if constexpr (N_LAUNCHES == 1) { if (IN(k) && IN((k) + 1)) cg::this_grid().sync(); } } while (0)

    if (IN(0)) { phase_prep(args, lds, wave, lane); }
    GRID_BAR(0);
    if (IN(1)) {
        pg8::Gemm g{(const bf16*)(ws + WS_R1), (const bf16*)(ws + WS_WIN), T, NPROJ, D}; pg8::StaticOrder S; S.init(T, NPROJ, G, (int)blockIdx.x);
        pg8::EpiBf16 E{(bf16*)(ws + WS_PROJ), NPROJ};
        pg8::gemm_phase<pg8::EpiBf16, pg8::StaticOrder, true, true>(lds, g, S, E);
    }
    GRID_BAR(1);
    if (IN(2)) { mix::phase_mixer(args, lds, tid, wave, lane); }
    GRID_BAR(2);
    if (IN(3)) {
        pg8::Gemm g{(const bf16*)(ws + WS_R1), (const bf16*)(ws + WS_WOUT), T, D, D}; pg8::StaticOrder S; S.init(T, D, G, (int)blockIdx.x);
        pg8::EpiBf16 E{(bf16*)(ws + WS_M), D};
        pg8::gemm_phase<pg8::EpiBf16, pg8::StaticOrder, true, true>(lds, g, S, E);
    }
    GRID_BAR(3);
    if (IN(4)) { phase_mid_norm(args, wave, lane); }
    GRID_BAR(4);
    if (IN(5)) {
        pg8::Gemm g{(const bf16*)(ws + WS_M), (const bf16*)(ws + WS_WGU), T, NGU, D}; pg8::StaticOrder S; S.init(T, NGU, G, (int)blockIdx.x);
        pg8::EpiSwiGLU E{(bf16*)(ws + WS_ACT), FF};
        pg8::gemm_phase<pg8::EpiSwiGLU, pg8::StaticOrder, true, true>(lds, g, S, E);
    }
    GRID_BAR(5);
    if (IN(6)) {
        pg8::Gemm g{(const bf16*)(ws + WS_ACT), (const bf16*)(ws + WS_WD), T, D, FF}; pg8::StaticOrder S; S.init(T, D, G, (int)blockIdx.x);
        pg8::EpiBf16 E{(bf16*)(ws + WS_M), D};
        pg8::gemm_phase<pg8::EpiBf16, pg8::StaticOrder, true, true>(lds, g, S, E);
    }
    GRID_BAR(6);
    if (IN(7)) { phase_final_norm(args, wave, lane); }
#undef IN
#undef GRID_BAR
}

extern "C" void kernel_launch(void* const* d_in, const int* in_sizes, int n_in, void* d_out, int out_size, void* d_ws, size_t ws_size, hipStream_t stream) {
    static int grid = 0;
    if (grid == 0) {
        if (n_in != 21 || out_size != T * D || ws_size < WS_END) { fprintf(stderr, "kernel_launch: unexpected problem (n_in %d, out %d, ws %zu)\n", n_in, out_size, ws_size); grid = -1; return; }
        int dev = 0, cus = 0, per_cu = 0;
        if (hipGetDevice(&dev) != hipSuccess || hipDeviceGetAttribute(&cus, hipDeviceAttributeMultiprocessorCount, dev) != hipSuccess) { grid = -1; return; }
        if (hipFuncSetAttribute((const void*)hymba_fwd, hipFuncAttributeMaxDynamicSharedMemorySize, LDS_BYTES) != hipSuccess) { fprintf(stderr, "kernel_launch: hipFuncSetAttribute failed\n"); grid = -1; return; }
        if (hipOccupancyMaxActiveBlocksPerMultiprocessor(&per_cu, (const void*)hymba_fwd, NWAVES * 64, LDS_BYTES) != hipSuccess || per_cu < 1) { fprintf(stderr, "kernel_launch: occupancy query failed (%d)\n", per_cu); (void)hipGetLastError(); grid = -1; return; }
        grid = cus * 1;
    }
    if (grid < 0) return;
    if (hipMemsetAsync((char*)d_ws + WS_CTL, 0, CTL_ZERO_BYTES, stream) != hipSuccess) return;
    Args a{};
    for (int i = 0; i < 21; ++i) a.in[i] = (const float*)d_in[i];
    a.out = (float*)d_out; a.ws = (unsigned char*)d_ws;
    if constexpr (N_LAUNCHES == 1) {
        a.ph_lo = 0; a.ph_hi = N_PHASES;
        void* kargs[] = {&a};
        const hipError_t e = hipLaunchCooperativeKernel((const void*)hymba_fwd, dim3(grid), dim3(NWAVES * 64), kargs, LDS_BYTES, stream);
        if (e != hipSuccess) fprintf(stderr, "kernel_launch: cooperative launch failed: %s (grid %d)\n", hipGetErrorString(e), grid);
    } else {
        for (int p = 0; p < N_PHASES; ++p) { a.ph_lo = p; a.ph_hi = p + 1; hipLaunchKernelGGL(hymba_fwd, dim3(grid), dim3(NWAVES * 64), LDS_BYTES, stream, a); }
    }
}
```
